# Optimizing an MI355X kernel written in HIP

```python
import functools
import jax, jax.numpy as jnp
from jax import lax
import numpy as np

D_MODEL = 1024
BATCH = 2
SEQ = 8192
DEPTH = 4
DEC_BATCH = 128
DEC_SEQ = 1
PAST_LEN = 8192
PAGE_SIZE = 128

N_HEADS_A = 8
N_KV_A = 2
HEAD_DIM_A = 64
GROUP_A = N_HEADS_A // N_KV_A
WINDOW = 128
BLOCK = WINDOW
N_HEADS_R = 4
DK_R = 128
DV_R = 256
CHUNK = 128
D_FF = 2816
ALPHA = (2.0 * DEPTH) ** 0.25
BETA = (8.0 * DEPTH) ** -0.25
LN_EPS = 1e-5
GN_EPS = 1e-6
NEG = -1e30

QA = N_HEADS_A * HEAD_DIM_A
KA = N_KV_A * HEAD_DIM_A
QR = N_HEADS_R * DK_R
VR = N_HEADS_R * DV_R
IN_COLS = QA + 2 * KA + 2 * QR + 2 * VR + 2 * D_MODEL
IN_SPLITS = (QA, QA + KA, QA + 2 * KA, QA + 2 * KA + QR, QA + 2 * KA + 2 * QR,
             QA + 2 * KA + 2 * QR + VR, QA + 2 * KA + 2 * QR + 2 * VR)

kernel_name = 'swa_sink_gqa_retention_macaron_deepnorm'


def layer_norm(x, g, b):
    xf = x.astype(jnp.float32)
    mu = jnp.mean(xf, axis=-1, keepdims=True)
    var = jnp.mean(jnp.square(xf - mu), axis=-1, keepdims=True)
    return ((xf - mu) * lax.rsqrt(var + LN_EPS) * g + b).astype(x.dtype)


def swiglu_half_step(x, w_gu, w_dn, g, b):
    a, u = jnp.split(x @ w_gu, 2, axis=-1)
    return layer_norm(ALPHA * x + 0.5 * ((jax.nn.silu(a) * u) @ w_dn), g, b)


def alibi_slopes():
    return 2.0 ** (-8.0 * jnp.arange(1, N_HEADS_A + 1, dtype=jnp.float32) / N_HEADS_A)


def retention_log_decay():
    return jnp.log1p(-(2.0 ** (-5.0 - jnp.arange(N_HEADS_R, dtype=jnp.float32))))


def sink_attend(q, k, v, dist, valid, sinks):
    s = jnp.einsum('...qkgd,...skd->...kgqs', q.astype(jnp.float32), k.astype(jnp.float32)) * (HEAD_DIM_A ** -0.5)
    slopes = alibi_slopes().reshape(N_KV_A, GROUP_A, 1, 1)
    s = jnp.where(valid, s - slopes * dist, NEG)
    sink = sinks.astype(jnp.float32).reshape(N_KV_A, GROUP_A, 1, 1)
    m = jnp.maximum(jnp.max(s, axis=-1, keepdims=True), sink)
    p = jnp.exp(s - m)
    p = p / (jnp.sum(p, axis=-1, keepdims=True) + jnp.exp(sink - m))
    return jnp.einsum('...kgqs,...skd->...qkgd', p, v.astype(jnp.float32))


def swa_prompt(q, k, v, sinks):
    B, T = q.shape[0], q.shape[1]
    nb = T // BLOCK
    qb = q.reshape(B, nb, BLOCK, N_KV_A, GROUP_A, HEAD_DIM_A)
    kb = k.reshape(B, nb, BLOCK, N_KV_A, HEAD_DIM_A)
    vb = v.reshape(B, nb, BLOCK, N_KV_A, HEAD_DIM_A)

    def with_prev(xb):
        prev = jnp.pad(xb[:, :-1], ((0, 0), (1, 0), (0, 0), (0, 0), (0, 0)))
        return jnp.concatenate([prev, xb], axis=2)

    i = jnp.arange(BLOCK)[:, None]
    j = jnp.arange(2 * BLOCK)[None, :]
    dist = i + BLOCK - j
    blk = jnp.arange(nb)[:, None, None]
    valid = (dist >= 0) & (dist <= WINDOW) & (blk * BLOCK - BLOCK + j >= 0)
    o = sink_attend(qb, with_prev(kb), with_prev(vb), dist.astype(jnp.float32), valid[:, None, None], sinks)
    return o.reshape(B, T, QA).astype(q.dtype), (k[:, -WINDOW:], v[:, -WINDOW:])


def swa_sample(q, k, v, sinks, cache_k, cache_v):
    DB, Tq = q.shape[0], q.shape[1]
    keys = jnp.concatenate([cache_k.astype(k.dtype), k], axis=1)
    vals = jnp.concatenate([cache_v.astype(v.dtype), v], axis=1)
    i = jnp.arange(Tq)[:, None]
    j = jnp.arange(WINDOW + Tq)[None, :]
    dist = i + WINDOW - j
    valid = (dist >= 0) & (dist <= WINDOW)
    o = sink_attend(q.reshape(DB, Tq, N_KV_A, GROUP_A, HEAD_DIM_A), keys, vals,
                    dist.astype(jnp.float32), valid, sinks)
    return o.reshape(DB, Tq, QA).astype(q.dtype), (keys[:, -WINDOW:], vals[:, -WINDOW:])


def retention_chunk(q, k, v, s0):
    lg = retention_log_decay()
    C = q.shape[1]
    pos = jnp.arange(C, dtype=jnp.float32)
    diff = pos[:, None] - pos[None, :]
    decay = jnp.where(diff >= 0, jnp.exp(jnp.maximum(diff, 0.0) * lg[:, None, None]), 0.0)
    qf, kf, vf = q.astype(jnp.float32), k.astype(jnp.float32), v.astype(jnp.float32)
    scores = jnp.einsum('bihd,bjhd->bhij', qf, kf) * decay
    o = jnp.einsum('bhij,bjhe->bihe', scores, vf)
    o = o + jnp.einsum('bihd,bhde->bihe', qf, s0) * jnp.exp((pos + 1.0)[:, None] * lg)[None, :, :, None]
    k_dec = kf * jnp.exp((C - 1.0 - pos)[:, None] * lg)[None, :, :, None]
    s_new = jnp.exp(C * lg)[None, :, None, None] * s0 + jnp.einsum('bjhd,bjhe->bhde', k_dec, vf)
    return o, s_new


def retention_prompt(q, k, v):
    B, T = q.shape[0], q.shape[1]
    nc = T // CHUNK

    def to_chunks(a):
        return jnp.transpose(a.reshape(B, nc, CHUNK, a.shape[2], a.shape[3]), (1, 0, 2, 3, 4))

    def step(s, qkv):
        o, s_new = retention_chunk(qkv[0], qkv[1], qkv[2], s)
        return s_new, o

    s0 = jnp.zeros((B, N_HEADS_R, DK_R, DV_R), jnp.float32)
    s_fin, o = lax.scan(step, s0, (to_chunks(q), to_chunks(k), to_chunks(v)))
    o = jnp.transpose(o, (1, 0, 2, 3, 4)).reshape(B, T, N_HEADS_R, DV_R)
    return o, s_fin


def retention_sample(q, k, v, state):
    return retention_chunk(q, k, v, state.astype(jnp.float32))


def mixing_sublayer(x, w_in, sinks, gn_g, w_br_a, w_br_r, w_o, g, b, attend, retain):
    Bx, T = x.shape[0], x.shape[1]
    z = x @ w_in
    q_a, k_a, v_a, q_r, k_r, v_r, g_r, gate = jnp.split(z, IN_SPLITS, axis=-1)
    o_a, win = attend(q_a.reshape(Bx, T, N_HEADS_A, HEAD_DIM_A),
                      k_a.reshape(Bx, T, N_KV_A, HEAD_DIM_A),
                      v_a.reshape(Bx, T, N_KV_A, HEAD_DIM_A), sinks)
    o_r, s_new = retain(q_r.reshape(Bx, T, N_HEADS_R, DK_R),
                        k_r.reshape(Bx, T, N_HEADS_R, DK_R) * (DK_R ** -0.5),
                        v_r.reshape(Bx, T, N_HEADS_R, DV_R))
    mu = jnp.mean(o_r, axis=-1, keepdims=True)
    var = jnp.mean(jnp.square(o_r - mu), axis=-1, keepdims=True)
    o_r = ((o_r - mu) * lax.rsqrt(var + GN_EPS)).reshape(Bx, T, VR) * gn_g
    o_r = (o_r * jax.nn.silu(g_r.astype(jnp.float32))).astype(x.dtype)
    g_a, g_b = jnp.split(jax.nn.sigmoid(gate), 2, axis=-1)
    merged = g_a * (o_a @ w_br_a) + g_b * (o_r @ w_br_r)
    return layer_norm(ALPHA * x + merged @ w_o, g, b), win, s_new


def setup_inputs(seed: int = 0) -> dict:
    key = jax.random.key(seed)
    ks = jax.random.split(key, 24)
    f32 = jnp.float32

    def nrm(k, shape, scale):
        return jax.random.normal(k, shape, f32) * scale

    col_scale = jnp.concatenate([
        jnp.ones((QA + KA,), f32), jnp.full((KA,), BETA, f32),
        jnp.ones((2 * QR,), f32), jnp.full((VR,), BETA, f32),
        jnp.ones((VR + 2 * D_MODEL,), f32)])
    return {
        'x_prompt': nrm(ks[0], (BATCH, SEQ, D_MODEL), 1.0),
        'x_sample': nrm(ks[1], (DEC_BATCH, DEC_SEQ, D_MODEL), 1.0),
        'cache_win_k': nrm(ks[2], (DEPTH, DEC_BATCH, WINDOW, N_KV_A, HEAD_DIM_A), 1.0),
        'cache_win_v': nrm(ks[3], (DEPTH, DEC_BATCH, WINDOW, N_KV_A, HEAD_DIM_A), BETA),
        'state_ret': nrm(ks[4], (DEPTH, DEC_BATCH, N_HEADS_R, DK_R, DV_R), 0.1),
        'w_ff1_gu': nrm(ks[5], (DEPTH, D_MODEL, 2 * D_FF), BETA * D_MODEL ** -0.5),
        'w_ff1_dn': nrm(ks[6], (DEPTH, D_FF, D_MODEL), BETA * D_FF ** -0.5),
        'ln1_g': 1.0 + nrm(ks[7], (DEPTH, D_MODEL), 0.02),
        'ln1_b': nrm(ks[8], (DEPTH, D_MODEL), 0.02),
        'w_in': nrm(ks[9], (DEPTH, D_MODEL, IN_COLS), D_MODEL ** -0.5) * col_scale,
        'attn_sinks': nrm(ks[10], (DEPTH, N_HEADS_A), 0.5),
        'ret_gn_g': 1.0 + nrm(ks[11], (DEPTH, VR), 0.02),
        'w_br_a': nrm(ks[12], (DEPTH, QA, D_MODEL), BETA * QA ** -0.5),
        'w_br_r': nrm(ks[13], (DEPTH, VR, D_MODEL), BETA * VR ** -0.5),
        'w_o': nrm(ks[14], (DEPTH, D_MODEL, D_MODEL), BETA * D_MODEL ** -0.5),
        'ln2_g': 1.0 + nrm(ks[15], (DEPTH, D_MODEL), 0.02),
        'ln2_b': nrm(ks[16], (DEPTH, D_MODEL), 0.02),
        'w_ff2_gu': nrm(ks[17], (DEPTH, D_MODEL, 2 * D_FF), BETA * D_MODEL ** -0.5),
        'w_ff2_dn': nrm(ks[18], (DEPTH, D_FF, D_MODEL), BETA * D_FF ** -0.5),
        'ln3_g': 1.0 + nrm(ks[19], (DEPTH, D_MODEL), 0.02),
        'ln3_b': nrm(ks[20], (DEPTH, D_MODEL), 0.02),
    }


def reference(x_prompt, x_sample, cache_win_k, cache_win_v, state_ret,
              w_ff1_gu, w_ff1_dn, ln1_g, ln1_b, w_in, attn_sinks, ret_gn_g,
              w_br_a, w_br_r, w_o, ln2_g, ln2_b, w_ff2_gu, w_ff2_dn, ln3_g, ln3_b):
    xp, xs = x_prompt, x_sample
    pk, pv, pr, sk, sv, sr = [], [], [], [], [], []
    for l in range(DEPTH):
        mix_w = (w_in[l], attn_sinks[l], ret_gn_g[l], w_br_a[l], w_br_r[l], w_o[l], ln2_g[l], ln2_b[l])
        xp = swiglu_half_step(xp, w_ff1_gu[l], w_ff1_dn[l], ln1_g[l], ln1_b[l])
        xs = swiglu_half_step(xs, w_ff1_gu[l], w_ff1_dn[l], ln1_g[l], ln1_b[l])
        xp, (k_new, v_new), s_new = mixing_sublayer(xp, *mix_w, swa_prompt, retention_prompt)
        pk.append(k_new)
        pv.append(v_new)
        pr.append(s_new)
        xs, (k_new, v_new), s_new = mixing_sublayer(
            xs, *mix_w,
            functools.partial(swa_sample, cache_k=cache_win_k[l], cache_v=cache_win_v[l]),
            functools.partial(retention_sample, state=state_ret[l]))
        sk.append(k_new)
        sv.append(v_new)
        sr.append(s_new)
        xp = swiglu_half_step(xp, w_ff2_gu[l], w_ff2_dn[l], ln3_g[l], ln3_b[l])
        xs = swiglu_half_step(xs, w_ff2_gu[l], w_ff2_dn[l], ln3_g[l], ln3_b[l])
    return (xp, xs, jnp.stack(pk), jnp.stack(pv), jnp.stack(pr), jnp.stack(sk), jnp.stack(sv), jnp.stack(sr))
```

```cpp
#include <hip/hip_runtime.h>
#include <hip/hip_cooperative_groups.h>
#include <cstdio>
#include <cstdint>
namespace cg = cooperative_groups;
namespace pg8 {
#define PG8_LAS __attribute__((address_space(3)))
typedef unsigned short bf16_t;
typedef short bf16x8 __attribute__((ext_vector_type(8)));
typedef float f32x4 __attribute__((ext_vector_type(4)));
typedef unsigned u32x4 __attribute__((ext_vector_type(4)));
constexpr int BM = 256, BK = 64, HALF = 128, HTB = HALF * BK * 2  , STAGE_BYTES = 8 * HTB, NXCD = 8, WGM = 8;

__host__ __device__ __forceinline__ int lds_byte(int r, int c) { const int st = (r >> 4) * 2 + (c >> 5), rr = r & 15, cc = c & 31, ob = rr * 64 + cc * 2; return st * 1024 + (ob ^ (((ob >> 9) & 1) << 5)); }
__host__ __device__ __forceinline__ void stage_rc(int b, int& R, int& C) { const int st = b / 1024, sb = b % 1024, swz = sb ^ (((sb >> 9) & 1) << 5); R = (st >> 1) * 16 + swz / 64; C = (st & 1) * 32 + (swz % 64) / 2; }
__host__ __device__ __forceinline__ int perm32(int rho) { const int n = rho >> 4, i = rho & 15; return 8 * (i >> 2) + 4 * n + (i & 3); }

struct Unit { int pm, pn; };
struct Gemm { const bf16_t* A; const bf16_t* Bt; int M, N, K; };

struct StaticOrder {
    int nM, nN, nwg, G, c;
    __host__ __device__ void init(int M, int N, int G_, int c_) { nM = M / BM; nN = N / BM; nwg = nM * nN; G = G_; c = c_; }
    __host__ __device__ bool next(int i, Unit& u) const {
        const long L = (long)i * G + c; if (L >= nwg) return false;
        int wgid = (int)L; { const int q = nwg / NXCD, r = nwg % NXCD, xcd = wgid % NXCD, off = wgid / NXCD; wgid = (xcd < r ? xcd * (q + 1) : r * (q + 1) + (xcd - r) * q) + off; }
        const int nig = WGM * nN, gid = wgid / nig, fm = gid * WGM, gsz = (nM - fm) < WGM ? (nM - fm) : WGM;
        u.pm = fm + ((wgid % nig) % gsz); u.pn = (wgid % nig) / gsz; return true;
    }
    __device__ __forceinline__ void a_ready(const Unit&) const {}
    __device__ __forceinline__ void done(const Unit&) const {}
};

__device__ __forceinline__ unsigned cvt_pk_bf16(float lo, float hi) { unsigned r; asm volatile("v_cvt_pk_bf16_f32 %0, %1, %2" : "=v"(r) : "v"(lo), "v"(hi)); return r; }
typedef float f32x2 __attribute__((ext_vector_type(2)));
__device__ __forceinline__ f32x2 gelu_pk(f32x2 v) {
    const f32x2 av = __builtin_elementwise_abs(v), d = av * 0.2316418882f + 1.0f;
    f32x2 t; t.x = __builtin_amdgcn_rcpf(d.x); t.y = __builtin_amdgcn_rcpf(d.y);
    f32x2 q = t * 0.5307027145f + (-0.7265760135f); q = q * t + 0.7107068705f; q = q * t + (-0.142248368f); q = q * t + 0.127414796f; q = q * t;
    const f32x2 s = (v * v) * (-0.72134752044f);
    f32x2 e; e.x = __builtin_amdgcn_exp2f(s.x); e.y = __builtin_amdgcn_exp2f(s.y);
    const f32x2 m = v * (q * e), r = v - m;
    f32x2 o; o.x = v.x < 0.f ? m.x : r.x; o.y = v.y < 0.f ? m.y : r.y; return o;
}

template <int ACT  > struct EpiBf16 {
    static constexpr bool PERM = true, AFTER_DRAIN = false; static_assert(ACT == 0 || ACT == 1, "EpiBf16: ACT is 0 (none) or 1 (gelu_pk)");
    bf16_t* O; int ldc; const float* bias; int split_cols; size_t split_stride; float scale0;
    __device__ __forceinline__ void operator()(const f32x4 (&acc)[2][2][4][2], const Unit& u, int wr, int wc, int fr, int fq) const {
        const int row0 = u.pm * BM + wr * 64 + fr; int colt = u.pn * BM; bf16_t* base = O;
        float sc = 1.f; if (split_cols) { const int t = colt / split_cols; base += (size_t)t * split_stride; colt -= t * split_cols; if (t == 0) sc = scale0; }
        const int col0 = colt + wc * 32 + 8 * fq, bcol0 = u.pn * BM + wc * 32 + 8 * fq;
        f32x4 bv[2][2];
#pragma unroll
        for (int bj = 0; bj < 2; ++bj)
#pragma unroll
            for (int n = 0; n < 2; ++n) bv[bj][n] = bias ? *(const f32x4*)(bias + bcol0 + bj * HALF + 4 * n) : (f32x4){0.f, 0.f, 0.f, 0.f};
#pragma unroll
        for (int ai = 0; ai < 2; ++ai)
#pragma unroll
            for (int m = 0; m < 4; ++m) { bf16_t* rowp = base + (size_t)(row0 + ai * HALF + m * 16) * ldc + col0;
#pragma unroll
                for (int bj = 0; bj < 2; ++bj) { f32x4 v0 = acc[ai][bj][m][0] + bv[bj][0], v1 = acc[ai][bj][m][1] + bv[bj][1];
                    if (ACT == 1) { f32x2 a = gelu_pk((f32x2){v0[0], v0[1]}), b = gelu_pk((f32x2){v0[2], v0[3]}), c = gelu_pk((f32x2){v1[0], v1[1]}), d = gelu_pk((f32x2){v1[2], v1[3]});
                        v0 = (f32x4){a.x, a.y, b.x, b.y}; v1 = (f32x4){c.x, c.y, d.x, d.y}; }
                    v0 = v0 * sc; v1 = v1 * sc; u32x4 w; w.x = cvt_pk_bf16(v0[0], v0[1]); w.y = cvt_pk_bf16(v0[2], v0[3]); w.z = cvt_pk_bf16(v1[0], v1[1]); w.w = cvt_pk_bf16(v1[2], v1[3]);
                    *(u32x4*)(rowp + bj * HALF) = w; } }
    }
};

struct PanelStats {
    unsigned* xbuf;
    unsigned* cnt;
    unsigned* tmo;
    int ntn; float eps;
    unsigned code;
    __device__ __forceinline__ bool run(const f32x4 (&v)[2][2][4][2], const Unit& u, int wr, int wc, int fr, int fq, PG8_LAS unsigned char* lds, int wid, int lane) const {
        typedef float f32x2v __attribute__((ext_vector_type(2)));
        PG8_LAS f32x2v* P = (PG8_LAS f32x2v*)lds;
        PG8_LAS f32x2v* S = (PG8_LAS f32x2v*)(lds + 8192);
        PG8_LAS unsigned* flag = (PG8_LAS unsigned*)(lds + 8192 + 2048);
#pragma unroll
        for (int ai = 0; ai < 2; ++ai)
#pragma unroll
            for (int m = 0; m < 4; ++m) {
                float s = 0.f;
#pragma unroll
                for (int bj = 0; bj < 2; ++bj)
#pragma unroll
                    for (int n = 0; n < 2; ++n) { const f32x4 x = v[ai][bj][m][n]; s += (x[0] + x[1]) + (x[2] + x[3]); }
                s += __shfl_xor(s, 16); s += __shfl_xor(s, 32);
                const float mw = s * (1.0f / 64.0f); float q = 0.f;
#pragma unroll
                for (int bj = 0; bj < 2; ++bj)
#pragma unroll
                    for (int n = 0; n < 2; ++n) { const f32x4 d = v[ai][bj][m][n] - mw; q += (d[0] * d[0] + d[1] * d[1]) + (d[2] * d[2] + d[3] * d[3]); }
                q += __shfl_xor(q, 16); q += __shfl_xor(q, 32);
                if (fq == 0) P[(ai * HALF + wr * 64 + m * 16 + fr) * 4 + wc] = (f32x2v){mw, q};
            }
        asm volatile("s_waitcnt lgkmcnt(0)" ::: "memory"); __builtin_amdgcn_s_barrier(); asm volatile("" ::: "memory");
#if defined(BROKEN_EXCHANGE_NO_WAIT)
#warning BROKEN CONTROL BUILD: the row-statistics exchange does not wait; results are wrong by design
        if (blockIdx.x >= 64) { const long long t0_ = clock64(); while (clock64() - t0_ < 60000) __builtin_amdgcn_s_sleep(8); }
#endif
        const int row = wid * 32 + (lane & 31);
        if (lane < 32) {
            const f32x2v a = P[row * 4 + 0], b = P[row * 4 + 1], c = P[row * 4 + 2], d = P[row * 4 + 3];
            const float mt = (a.x + b.x + c.x + d.x) * 0.25f;
            const float da = a.x - mt, db = b.x - mt, dc = c.x - mt, dd = d.x - mt;
            const float m2 = (a.y + b.y) + (c.y + d.y) + 64.0f * ((da * da + db * db) + (dc * dc + dd * dd));
            unsigned long long* slot = (unsigned long long*)xbuf + ((size_t)(u.pm * BM + row) * 4 + u.pn);
            __hip_atomic_store(slot, ((unsigned long long)__float_as_uint(m2) << 32) | __float_as_uint(mt), __ATOMIC_RELAXED, __HIP_MEMORY_SCOPE_AGENT);
        }
        asm volatile("s_waitcnt vmcnt(0)" ::: "memory");
        if (lane == 0) __hip_atomic_fetch_add(cnt + 64 * u.pm, 1u, __ATOMIC_RELAXED, __HIP_MEMORY_SCOPE_AGENT);
        if (wid == 0) {
            bool dead = false; const unsigned long long t0 = __builtin_amdgcn_s_memrealtime(); const unsigned want = 8u * (unsigned)ntn;
            for (;;) {
#if defined(BROKEN_EXCHANGE_NO_WAIT)
                break;
#endif
                if ((unsigned)__builtin_amdgcn_readfirstlane(__hip_atomic_load(cnt + 64 * u.pm, __ATOMIC_RELAXED, __HIP_MEMORY_SCOPE_AGENT)) >= want) break;
                if (__builtin_amdgcn_s_memrealtime() - t0 > 2000000ull) {
                    if (lane == 0) { unsigned expect = 0u; __hip_atomic_compare_exchange_strong(tmo + 1, &expect, code | (unsigned)(u.pm & 0xff), __ATOMIC_RELAXED, __ATOMIC_RELAXED, __HIP_MEMORY_SCOPE_AGENT);
                                     __hip_atomic_store(tmo, 1u, __ATOMIC_RELAXED, __HIP_MEMORY_SCOPE_AGENT); }
                    dead = true; break; }
                __builtin_amdgcn_s_sleep(2);
            }
            __builtin_amdgcn_fence(__ATOMIC_ACQUIRE, "agent");
            if (lane == 0) flag[0] = dead ? 1u : 0u;
        }
        asm volatile("s_waitcnt vmcnt(0) lgkmcnt(0)" ::: "memory"); __builtin_amdgcn_s_barrier(); asm volatile("" ::: "memory");
        const bool bad = flag[0] != 0u;
        if (lane < 32) {
            const unsigned long long* slot = (const unsigned long long*)xbuf + (size_t)(u.pm * BM + row) * 4; float mt[4], m2[4]; float ms = 0.f;
#pragma unroll
            for (int t = 0; t < 4; ++t) { if (t < ntn) { const unsigned long long w = __hip_atomic_load(slot + t, __ATOMIC_RELAXED, __HIP_MEMORY_SCOPE_AGENT); mt[t] = __uint_as_float((unsigned)w); m2[t] = __uint_as_float((unsigned)(w >> 32)); } else { mt[t] = 0.f; m2[t] = 0.f; } ms += mt[t]; }
            const float mean = ms / (float)ntn; float q = 0.f;
#pragma unroll
            for (int t = 0; t < 4; ++t) if (t < ntn) { const float dm = mt[t] - mean; q += m2[t] + 256.0f * dm * dm; }
            S[row] = (f32x2v){mean, 1.0f / sqrtf(q / (256.0f * (float)ntn) + eps)};
        }
        asm volatile("s_waitcnt lgkmcnt(0)" ::: "memory"); __builtin_amdgcn_s_barrier(); asm volatile("" ::: "memory");
        return bad;
    }
};
struct EpiLnRes {
    static constexpr bool PERM = false, AFTER_DRAIN = true;
    const float* base; float* out; int ldc; const float* bias; PanelStats st; unsigned poison;
    __device__ __forceinline__ void fused(f32x4 (&acc)[2][2][4][2], const Unit& u, int wr, int wc, int fr, int fq, PG8_LAS unsigned char* lds, int wid, int lane) const {
        typedef float f32x2v __attribute__((ext_vector_type(2)));
        const PG8_LAS f32x2v* S = (const PG8_LAS f32x2v*)(lds + 8192);
        const int col0 = u.pn * BM + wc * 32 + 4 * fq;
#pragma unroll
        for (int bj = 0; bj < 2; ++bj)
#pragma unroll
            for (int n = 0; n < 2; ++n) { const f32x4 bv = bias ? *(const f32x4*)(bias + col0 + bj * HALF + n * 16) : (f32x4){0.f, 0.f, 0.f, 0.f};
#pragma unroll
                for (int ai = 0; ai < 2; ++ai)
#pragma unroll
                    for (int m = 0; m < 4; ++m) acc[ai][bj][m][n] += bv; }
        f32x4 pre[4][2][2];
#pragma unroll
        for (int m = 0; m < 4; ++m) { const size_t off = (size_t)(u.pm * BM + wr * 64 + m * 16 + fr) * ldc + col0;
#pragma unroll
            for (int bj = 0; bj < 2; ++bj)
#pragma unroll
                for (int n = 0; n < 2; ++n) pre[m][bj][n] = *(const f32x4*)(base + off + bj * HALF + n * 16); }
        const bool bad = st.run(acc, u, wr, wc, fr, fq, lds, wid, lane) || poison != 0u;
        const float qnan = __builtin_nanf("");
#pragma unroll
        for (int ai = 0; ai < 2; ++ai)
#pragma unroll
            for (int m = 0; m < 4; ++m) { const int r = ai * HALF + wr * 64 + m * 16 + fr; const f32x2v sr = S[r]; const size_t off = (size_t)(u.pm * BM + r) * ldc + col0;
#pragma unroll
                for (int bj = 0; bj < 2; ++bj)
#pragma unroll
                    for (int n = 0; n < 2; ++n) { const f32x4 bs = ai == 0 ? pre[m][bj][n] : *(const f32x4*)(base + off + bj * HALF + n * 16); f32x4 o = bs + (acc[ai][bj][m][n] - sr.x) * sr.y;
                        if (bad) o = (f32x4){qnan, qnan, qnan, qnan}; *(f32x4*)(out + off + bj * HALF + n * 16) = o; }
                if (m & 1) asm volatile("" ::: "memory"); }
    }
};
struct EpiLnResLn {
    static constexpr bool PERM = false, AFTER_DRAIN = true;
    const float* base; float* out; bf16_t* xn; int ldc; const float* bias; PanelStats st1, st2; unsigned poison;
    __device__ __forceinline__ void fused(f32x4 (&acc)[2][2][4][2], const Unit& u, int wr, int wc, int fr, int fq, PG8_LAS unsigned char* lds, int wid, int lane) const {
        typedef float f32x2v __attribute__((ext_vector_type(2))); typedef unsigned u32x2v __attribute__((ext_vector_type(2)));
        const PG8_LAS f32x2v* S = (const PG8_LAS f32x2v*)(lds + 8192);
        const int col0 = u.pn * BM + wc * 32 + 4 * fq;
#pragma unroll
        for (int bj = 0; bj < 2; ++bj)
#pragma unroll
            for (int n = 0; n < 2; ++n) { const f32x4 bv = bias ? *(const f32x4*)(bias + col0 + bj * HALF + n * 16) : (f32x4){0.f, 0.f, 0.f, 0.f};
#pragma unroll
                for (int ai = 0; ai < 2; ++ai)
#pragma unroll
                    for (int m = 0; m < 4; ++m) acc[ai][bj][m][n] += bv; }
        bool bad = st1.run(acc, u, wr, wc, fr, fq, lds, wid, lane) || poison != 0u;
        const float qnan = __builtin_nanf("");
#pragma unroll
        for (int ai = 0; ai < 2; ++ai)
#pragma unroll
            for (int m = 0; m < 4; ++m) { const int r = ai * HALF + wr * 64 + m * 16 + fr; const f32x2v sr = S[r]; const size_t off = (size_t)(u.pm * BM + r) * ldc + col0;
#pragma unroll
                for (int bj = 0; bj < 2; ++bj)
#pragma unroll
                    for (int n = 0; n < 2; ++n) { const f32x4 bs = *(const f32x4*)(base + off + bj * HALF + n * 16); acc[ai][bj][m][n] = bs + (acc[ai][bj][m][n] - sr.x) * sr.y; }
                asm volatile("" : "+v"(acc[ai][0][m][0]), "+v"(acc[ai][0][m][1]), "+v"(acc[ai][1][m][0]), "+v"(acc[ai][1][m][1]));
                if (m & 1) asm volatile("" ::: "memory"); }
        const bool bad1 = bad;
        bad = st2.run(acc, u, wr, wc, fr, fq, lds, wid, lane) || bad;
#pragma unroll
        for (int ai = 0; ai < 2; ++ai)
#pragma unroll
            for (int m = 0; m < 4; ++m) { const int r = ai * HALF + wr * 64 + m * 16 + fr; const f32x2v sr = S[r]; const size_t off = (size_t)(u.pm * BM + r) * ldc + col0;
#pragma unroll
                for (int bj = 0; bj < 2; ++bj)
#pragma unroll
                    for (int n = 0; n < 2; ++n) { const f32x4 x1 = acc[ai][bj][m][n]; *(f32x4*)(out + off + bj * HALF + n * 16) = bad1 ? (f32x4){qnan, qnan, qnan, qnan} : x1;
                        const f32x4 o = (x1 - sr.x) * sr.y; u32x2v w; w.x = cvt_pk_bf16(o[0], o[1]); w.y = cvt_pk_bf16(o[2], o[3]);
                        if (bad) { w.x = 0x7fc07fc0u; w.y = 0x7fc07fc0u; } *(u32x2v*)(xn + off + bj * HALF + n * 16) = w; }
                asm volatile("" ::: "memory"); }
    }
};

template <class Epi, class Sched, bool ALIGN_EPI = false, bool SP2 = false>
__device__ __forceinline__ void gemm_phase(PG8_LAS unsigned char* lds, const Gemm g, const Sched& S, const Epi& E) {
    int tid_l = threadIdx.x; asm volatile("" : "+v"(tid_l));
    const int tid = tid_l, wid = __builtin_amdgcn_readfirstlane(tid >> 6), lane = tid & 63, wr = wid >> 2, wc = wid & 3, fr = lane & 15, fq = lane >> 4;
    const int K = g.K, nt = K / BK;
    unsigned voffA[2], voffB[2];
#pragma unroll
    for (int i = 0; i < 2; ++i) { int R, C; stage_rc(tid * 16 + i * 8192, R, C); const int Rb = Epi::PERM ? ((R & ~31) + perm32(R & 31)) : R;
        voffA[i] = (unsigned)(R * K + C) * 2u; voffB[i] = (unsigned)(Rb * K + C) * 2u; }
    const size_t kstep = (size_t)(BK * 2);
    const size_t hstep = (size_t)HALF * K * 2;
    const size_t tstep = 2 * hstep;
    const unsigned ldsw = (unsigned)wid * 1024u;
    const int aoff = lds_byte(wr * 64 + fr, fq * 8), boff = lds_byte(wc * 32 + fr, fq * 8);
#define PG8_SA(b, h) (((b) * 2 + (h)) * HTB)
#define PG8_SB(b, h) ((4 + (b) * 2 + (h)) * HTB)
#define PG8_STAGE(bufoff, gbase, voff) do { _Pragma("unroll") for (int _i = 0; _i < 2; ++_i) \
        __builtin_amdgcn_global_load_lds((const unsigned*)((const char*)(gbase) + (voff)[_i]), (PG8_LAS unsigned*)(lds + (bufoff) + ldsw + _i * 8192), 16, 0, 0); } while (0)
#define PG8_LDA(dst, b, h) do { _Pragma("unroll") for (int m = 0; m < 4; ++m) _Pragma("unroll") for (int k = 0; k < 2; ++k) dst[m][k] = *(const PG8_LAS bf16x8*)(lds + PG8_SA(b, h) + aoff + m * 2048 + k * 1024); } while (0)
#define PG8_LDB(dst, b, h) do { _Pragma("unroll") for (int n = 0; n < 2; ++n) _Pragma("unroll") for (int k = 0; k < 2; ++k) dst[n][k] = *(const PG8_LAS bf16x8*)(lds + PG8_SB(b, h) + boff + n * 2048 + k * 1024); } while (0)
#define PG8_MMA(ai, bj, At, Bt) do { __builtin_amdgcn_s_setprio(1); _Pragma("unroll") for (int m = 0; m < 4; ++m) _Pragma("unroll") for (int n = 0; n < 2; ++n) _Pragma("unroll") for (int k = 0; k < 2; ++k) \
        acc[ai][bj][m][n] = __builtin_amdgcn_mfma_f32_16x16x32_bf16(Bt[n][k], At[m][k], acc[ai][bj][m][n], 0, 0, 0); __builtin_amdgcn_s_setprio(0); } while (0)
#define PG8_WAIT_V(n) asm volatile("s_waitcnt vmcnt(" #n ")" ::: "memory")
#define PG8_WAIT_L(n) asm volatile("s_waitcnt lgkmcnt(" #n ")" ::: "memory")
#define PG8_BAR __builtin_amdgcn_s_barrier()
#define PG8_SCHED __builtin_amdgcn_sched_barrier(0)
    Unit cur, nxt; int ui = 0;
    if (!S.next(0, cur)) return;
    f32x4 acc[2][2][4][2];
#pragma unroll
    for (int a = 0; a < 2; ++a)
#pragma unroll
        for (int b = 0; b < 2; ++b)
#pragma unroll
            for (int m = 0; m < 4; ++m)
#pragma unroll
                for (int n = 0; n < 2; ++n) acc[a][b][m][n] = (f32x4){0.f, 0.f, 0.f, 0.f};
    bf16x8 At[4][2], B0[2][2], B1[2][2];
    const char* cA = (const char*)g.A + (size_t)cur.pm * tstep; const char* cB = (const char*)g.Bt + (size_t)cur.pn * tstep;
    S.a_ready(cur);
    if constexpr (SP2) {
        PG8_STAGE(PG8_SB(0, 0), cB, voffB); PG8_STAGE(PG8_SB(0, 1), cB + hstep, voffB); PG8_STAGE(PG8_SA(0, 0), cA, voffA); PG8_STAGE(PG8_SA(0, 1), cA + hstep, voffA);
        if (wr == 1) PG8_BAR;
        PG8_WAIT_V(2); PG8_BAR;
        PG8_STAGE(PG8_SB(1, 0), cB + kstep, voffB); PG8_STAGE(PG8_SA(1, 0), cA + kstep, voffA); PG8_STAGE(PG8_SB(1, 1), cB + hstep + kstep, voffB);
        PG8_WAIT_V(6); PG8_BAR;
    } else {
        PG8_STAGE(PG8_SB(0, 0), cB, voffB); PG8_STAGE(PG8_SA(0, 0), cA, voffA); PG8_STAGE(PG8_SB(0, 1), cB + hstep, voffB); PG8_STAGE(PG8_SA(0, 1), cA + hstep, voffA);
        if (wr == 1) PG8_BAR;
        PG8_WAIT_V(4); PG8_BAR;
        PG8_STAGE(PG8_SB(1, 0), cB + kstep, voffB); PG8_STAGE(PG8_SA(1, 0), cA + kstep, voffA); PG8_STAGE(PG8_SB(1, 1), cB + hstep + kstep, voffB);
        PG8_WAIT_V(6); PG8_BAR;
    }
    for (;;) {
        const bool has_next = S.next(ui + 1, nxt);
        const char* nA = has_next ? (const char*)g.A + (size_t)nxt.pm * tstep : cA; const char* nB = has_next ? (const char*)g.Bt + (size_t)nxt.pn * tstep : cB;
        for (int t = 0; t < nt; t += 2) {
            const bool last = (t == nt - 2);
            const char* a1 = cA + (size_t)(t + 1) * kstep;
            const char* a2 = last ? nA : cA + (size_t)(t + 2) * kstep; const char* b2 = last ? nB : cB + (size_t)(t + 2) * kstep;
            const char* a3 = a2 + kstep; const char* b3 = b2 + kstep;
            if (last && has_next) S.a_ready(nxt);
            if constexpr (SP2) {
            PG8_LDB(B0, 0, 0); PG8_LDB(B1, 0, 1); PG8_SCHED; PG8_LDA(At, 0, 0); PG8_STAGE(PG8_SA(1, 1), a1 + hstep, voffA);
            PG8_WAIT_V(8); PG8_WAIT_L(0); PG8_BAR; PG8_MMA(0, 0, At, B0); PG8_MMA(0, 1, At, B1); PG8_BAR; PG8_SCHED;
            PG8_LDA(At, 0, 1); PG8_STAGE(PG8_SB(0, 0), b2, voffB); PG8_STAGE(PG8_SB(0, 1), b2 + hstep, voffB); PG8_STAGE(PG8_SA(0, 0), a2, voffA);
            PG8_WAIT_V(8); PG8_WAIT_L(0); PG8_BAR; PG8_MMA(1, 0, At, B0); PG8_MMA(1, 1, At, B1); PG8_BAR; PG8_SCHED;
            PG8_LDB(B0, 1, 0); PG8_LDB(B1, 1, 1); PG8_SCHED; PG8_LDA(At, 1, 0); PG8_STAGE(PG8_SA(0, 1), a2 + hstep, voffA);
            PG8_WAIT_V(8); PG8_WAIT_L(0); PG8_BAR; PG8_MMA(0, 0, At, B0); PG8_MMA(0, 1, At, B1); PG8_BAR; PG8_SCHED;
            PG8_LDA(At, 1, 1); PG8_STAGE(PG8_SB(1, 0), b3, voffB); PG8_STAGE(PG8_SB(1, 1), b3 + hstep, voffB); PG8_STAGE(PG8_SA(1, 0), a3, voffA);
            PG8_WAIT_V(8); PG8_WAIT_L(0); PG8_BAR; PG8_MMA(1, 0, At, B0); PG8_MMA(1, 1, At, B1); PG8_BAR; PG8_SCHED;
            } else {
            PG8_LDB(B0, 0, 0); PG8_SCHED; PG8_LDA(At, 0, 0); PG8_STAGE(PG8_SA(1, 1), a1 + hstep, voffA);
            PG8_WAIT_L(8); PG8_BAR; PG8_WAIT_L(0); PG8_MMA(0, 0, At, B0); PG8_BAR; PG8_SCHED;
            PG8_LDB(B1, 0, 1); PG8_STAGE(PG8_SB(0, 0), b2, voffB);
            PG8_BAR; PG8_WAIT_L(0); PG8_MMA(0, 1, At, B1); PG8_BAR;
            PG8_LDA(At, 0, 1); PG8_STAGE(PG8_SA(0, 0), a2, voffA);
            PG8_BAR; PG8_WAIT_L(0); PG8_MMA(1, 0, At, B0); PG8_BAR; PG8_SCHED;
            PG8_STAGE(PG8_SB(0, 1), b2 + hstep, voffB);
            PG8_WAIT_V(6); PG8_BAR; PG8_MMA(1, 1, At, B1); PG8_BAR;
            PG8_LDB(B0, 1, 0); PG8_SCHED; PG8_LDA(At, 1, 0); PG8_STAGE(PG8_SA(0, 1), a2 + hstep, voffA);
            PG8_WAIT_L(8); PG8_BAR; PG8_WAIT_L(0); PG8_MMA(0, 0, At, B0); PG8_BAR; PG8_SCHED;
            PG8_LDB(B1, 1, 1); PG8_STAGE(PG8_SB(1, 0), b3, voffB);
            PG8_BAR; PG8_WAIT_L(0); PG8_MMA(0, 1, At, B1); PG8_BAR;
            PG8_LDA(At, 1, 1); PG8_STAGE(PG8_SA(1, 0), a3, voffA);
            PG8_BAR; PG8_WAIT_L(0); PG8_MMA(1, 0, At, B0); PG8_BAR; PG8_SCHED;
            PG8_STAGE(PG8_SB(1, 1), b3 + hstep, voffB);
            PG8_WAIT_V(6); PG8_BAR; PG8_MMA(1, 1, At, B1); PG8_BAR;
            }
        }
        if constexpr (ALIGN_EPI) { if (wr == 0) PG8_BAR; }
        if constexpr (!Epi::AFTER_DRAIN) { E(acc, cur, wr, wc, fr, fq); S.done(cur); }
        if (!has_next) break;
#pragma unroll
        for (int a = 0; a < 2; ++a)
#pragma unroll
            for (int b = 0; b < 2; ++b)
#pragma unroll
                for (int m = 0; m < 4; ++m)
#pragma unroll
                    for (int n = 0; n < 2; ++n) acc[a][b][m][n] = (f32x4){0.f, 0.f, 0.f, 0.f};
        cur = nxt; cA = nA; cB = nB; ++ui;
        if constexpr (ALIGN_EPI) { if (wr == 1) PG8_BAR; }
    }
    PG8_WAIT_V(0);
    if constexpr (!ALIGN_EPI) { if (wr == 0) PG8_BAR; }
    PG8_BAR;
    if constexpr (Epi::AFTER_DRAIN) { E.fused(acc, cur, wr, wc, fr, fq, lds, wid, lane); S.done(cur); }
#undef PG8_SA
#undef PG8_SB
#undef PG8_STAGE
#undef PG8_LDA
#undef PG8_LDB
#undef PG8_MMA
#undef PG8_WAIT_V
#undef PG8_WAIT_L
#undef PG8_BAR
#undef PG8_SCHED
}
}
#define GAS __attribute__((address_space(1)))
#define LAS __attribute__((address_space(3)))
typedef unsigned short bf16;
typedef unsigned v4u __attribute__((ext_vector_type(4)));
typedef float f32x4 __attribute__((ext_vector_type(4)));
typedef short bf16x8 __attribute__((ext_vector_type(8)));
typedef GAS unsigned gu32;
typedef GAS unsigned long long gu64;
#define RLX_AGENT __ATOMIC_RELAXED, __HIP_MEMORY_SCOPE_AGENT
#define LDS_WAIT() asm volatile("s_waitcnt lgkmcnt(0)" ::: "memory")
#define VM_WAIT() asm volatile("s_waitcnt vmcnt(0)" ::: "memory")
__device__ __forceinline__ unsigned long long rt() { return __builtin_amdgcn_s_memrealtime(); }
__device__ __forceinline__ unsigned f2bf(float f) { unsigned u = __builtin_bit_cast(unsigned, f); return (u + 0x7fffu + ((u >> 16) & 1u)) >> 16; }
__device__ __forceinline__ unsigned pk2(float lo, float hi) { return f2bf(lo) | (f2bf(hi) << 16); }
#define XB_TMO      128
#define XB_XCNT(j)  (256  + 64 * (j))
#define XB_XSUB(j)  (1280 + 64 * (j))
#define XB_XGEN(j)  (2304 + 64 * (j))
#define XB_TOP      3328
#define XB_TOPGEN   3392
#define XCD_BAR_WORDS 3456
#define XB_SPIN_CAP (1u << 18)

__device__ __forceinline__ unsigned xb_ld(unsigned* p)              { return __hip_atomic_load(p, __ATOMIC_RELAXED, __HIP_MEMORY_SCOPE_AGENT); }
__device__ __forceinline__ unsigned xb_add(unsigned* p, unsigned v) { return __hip_atomic_fetch_add(p, v, __ATOMIC_RELAXED, __HIP_MEMORY_SCOPE_AGENT); }
__device__ __forceinline__ unsigned xb_xcc_id() { return (unsigned)__builtin_amdgcn_s_getreg((3 << 11) | 20) & 0xFu; }
#define XB_SPIN(cond, bar) do { unsigned _sp = 0; while (cond) { __builtin_amdgcn_s_sleep(1); \
    if ((++_sp & 255u) == 0u) { if (xb_ld(&(bar)[XB_TMO])) break; if (_sp > XB_SPIN_CAP) { atomicAdd(&(bar)[XB_TMO], 1u); break; } } } } while (0)

struct XcdBarrier {
    unsigned* bar; unsigned x;
    volatile LAS unsigned* st;
};

__device__ __forceinline__ XcdBarrier xcd_barrier_post(unsigned* bar, volatile LAS unsigned* st) {
    XcdBarrier b; b.bar = bar; b.x = xb_xcc_id(); b.st = st;
    if (threadIdx.x == 0) (void)xb_add(&bar[XB_XCNT(b.x)], 1u);
    return b;
}
__device__ __forceinline__ void xcd_barrier_complete(unsigned* bar, unsigned x, unsigned& nloc, unsigned& nx) {
    const unsigned G = gridDim.x * gridDim.y * gridDim.z;
    unsigned sum, cnt, mine, sp = 0u;
    for (;;) {
        sum = 0u; cnt = 0u; mine = 0u;
#pragma unroll
        for (unsigned j = 0; j < 16; ++j) { const unsigned c = xb_ld(&bar[XB_XCNT(j)]); sum += c; cnt += (c > 0u) ? 1u : 0u; mine = (j == x) ? c : mine; }
        if (sum == G) break;
        __builtin_amdgcn_s_sleep(1);
        if ((++sp & 255u) == 0u) { if (xb_ld(&bar[XB_TMO])) break; if (sp > XB_SPIN_CAP) { atomicAdd(&bar[XB_TMO], 1u); break; } }
    }
    nloc = mine > 0u ? mine : 1u; nx = cnt > 0u ? cnt : 1u;
}

__device__ __forceinline__ void xcd_barrier(const XcdBarrier& b) {
    asm volatile("s_waitcnt vmcnt(0)" ::: "memory");
    __syncthreads();
    if (threadIdx.x == 0) {
        unsigned* bar = b.bar;
        __builtin_amdgcn_s_waitcnt(0);
        unsigned nloc = b.st[0], nx = b.st[1];
        if (nloc == 0u) { xcd_barrier_complete(bar, b.x, nloc, nx); b.st[0] = nloc; b.st[1] = nx; }
        const unsigned old = xb_add(&bar[XB_XSUB(b.x)], 1u);
        const unsigned gen = old / nloc;
        if (old + 1u == (gen + 1u) * nloc) {
            __builtin_amdgcn_fence(__ATOMIC_RELEASE, "agent");
            asm volatile("s_waitcnt vmcnt(0)" ::: "memory");
            const unsigned og = xb_add(&bar[XB_TOP], 1u);
            const unsigned tg = og / nx;
            if (og + 1u == (tg + 1u) * nx) xb_add(&bar[XB_TOPGEN], 1u);
            else XB_SPIN(xb_ld(&bar[XB_TOPGEN]) == tg, bar);
            __builtin_amdgcn_fence(__ATOMIC_ACQUIRE, "agent");
            xb_add(&bar[XB_XGEN(b.x)], 1u);
            asm volatile("s_waitcnt vmcnt(0)" ::: "memory");
        } else {
            XB_SPIN(xb_ld(&bar[XB_XGEN(b.x)]) == gen, bar);
            __builtin_amdgcn_fence(__ATOMIC_ACQUIRE, "agent");
            asm volatile("s_waitcnt vmcnt(0)" ::: "memory");
        }
    }
    __syncthreads();
}
#ifndef MK_SINGLE
#define MK_SINGLE 1
#endif
#ifndef MK_USE_CG
#define MK_USE_CG 0
#endif
constexpr int DM = 1024, SEQ = 8192, NBATCH = 2, MP = NBATCH * SEQ, DBATCH = 128, MT = MP + 256, DEPTH = 4, DFF = 2816, NGU = 2 * DFF, ZP = 5888;
constexpr int QA_OFF = 0, KA_OFF = 512, VA_OFF = 640, QR_OFF = 768, KR_OFF = 1280, VR_OFF = 1792, GR_OFF = 2816, GA_OFF = 3840, GB_OFF = 4864;
constexpr float ALPHA = 1.681792830507429f, LN_EPS = 1e-5f, GN_EPS = 1e-6f, LOG2E = 1.4426950408889634f;
constexpr size_t MiB = 1u << 20;
constexpr size_t WS_CTL = 0, CTL_BYTES = 1 * MiB;
constexpr size_t WS_W = 2 * MiB, WL_STRIDE = 50 * MiB;
constexpr size_t WO_GU1 = 0, WO_DN1 = 11534336, WO_WIN = 17301504, WO_BRA = 29360128, WO_BRR = 30408704, WO_WO = 32505856, WO_GU2 = 34603008, WO_DN2 = 46137344;
constexpr size_t WS_X = 204 * MiB, WS_V = 270 * MiB, WS_XN = 336 * MiB, WS_Z = 370 * MiB, WS_H = WS_Z, WS_OA = 558 * MiB, WS_OR = 576 * MiB, WS_MG = 610 * MiB,
                 WS_TMP = 644 * MiB, WS_U = 710 * MiB, WS_SC = 774 * MiB, WS_END = 806 * MiB;
constexpr int CW_BAR = 4096;
constexpr size_t O_YP = 0, O_YS = 16777216, O_WKP = 16908288, O_WVP = 17039360, O_RP = 17170432, O_WKS = 18219008, O_WVS = 26607616, O_RS = 34996224, O_TOTAL = 102105088;
constexpr int RING_BYTES = 131072, MISC_OFF = RING_BYTES, LDS_BYTES = RING_BYTES + 1024;
constexpr int NPH_LAYER = 13, NPHASES = 1 + NPH_LAYER * DEPTH;

typedef float f32x2_t __attribute__((ext_vector_type(2)));
typedef __bf16 bf16x2_t __attribute__((ext_vector_type(2)));
typedef unsigned u32x2 __attribute__((ext_vector_type(2)));
#define DI __device__ __forceinline__
#define MFMA16(a, b, c) __builtin_amdgcn_mfma_f32_16x16x32_bf16((a), (b), (c), 0, 0, 0)
DI unsigned cvtpk(float lo, float hi) { f32x2_t v = {lo, hi}; bf16x2_t b = __builtin_convertvector(v, bf16x2_t); return __builtin_bit_cast(unsigned, b); }
DI float bflo(unsigned u) { return __uint_as_float(u << 16); }
DI float bfhi(unsigned u) { return __uint_as_float(u & 0xffff0000u); }
DI float bf2f(bf16 v) { return __uint_as_float(((unsigned)v) << 16); }
DI float fexp2(float x) { return __builtin_amdgcn_exp2f(x); }
DI float fexp(float x) { return __builtin_amdgcn_exp2f(x * LOG2E); }
DI float sigmoidf_(float x) { return __builtin_amdgcn_rcpf(1.f + fexp(-x)); }
DI float siluf_(float x) { return x * sigmoidf_(x); }
DI bf16x8 mk8(u32x2 lo, u32x2 hi) { v4u t = {lo.x, lo.y, hi.x, hi.y}; return __builtin_bit_cast(bf16x8, t); }
DI float wave_sum(float v) {
#pragma unroll
    for (int o = 1; o < 64; o <<= 1) v += __shfl_xor(v, o);
    return v;
}
DI float wave_max(float v) {
#pragma unroll
    for (int o = 1; o < 64; o <<= 1) v = fmaxf(v, __shfl_xor(v, o));
    return v;
}

struct EpiSwiglu {
    static constexpr bool PERM = true, AFTER_DRAIN = false;
    bf16* H;
    DI void operator()(const f32x4 (&acc)[2][2][4][2], const pg8::Unit& u, int wr, int wc, int fr, int fq) const {
        const int row0 = u.pm * 256 + wr * 64 + fr, col0 = u.pn * 128 + wc * 32 + 8 * fq;
#pragma unroll
        for (int ai = 0; ai < 2; ++ai)
#pragma unroll
            for (int m = 0; m < 4; ++m) {
                const f32x4 a0 = acc[ai][0][m][0], a1 = acc[ai][0][m][1], u0 = acc[ai][1][m][0], u1 = acc[ai][1][m][1];
                v4u w;
                w.x = cvtpk(siluf_(a0[0]) * u0[0], siluf_(a0[1]) * u0[1]); w.y = cvtpk(siluf_(a0[2]) * u0[2], siluf_(a0[3]) * u0[3]);
                w.z = cvtpk(siluf_(a1[0]) * u1[0], siluf_(a1[1]) * u1[1]); w.w = cvtpk(siluf_(a1[2]) * u1[2], siluf_(a1[3]) * u1[3]);
                *(v4u*)(H + (size_t)(row0 + ai * 128 + m * 16) * DFF + col0) = w;
            }
    }
};
struct EpiRes {
    static constexpr bool PERM = false, AFTER_DRAIN = false;
    const float* X; float* V; float coef;
    DI void operator()(const f32x4 (&acc)[2][2][4][2], const pg8::Unit& u, int wr, int wc, int fr, int fq) const {
        const int row0 = u.pm * 256 + wr * 64 + fr, col0 = u.pn * 256 + wc * 32 + 4 * fq;
#pragma unroll
        for (int ai = 0; ai < 2; ++ai)
#pragma unroll
            for (int m = 0; m < 4; ++m) {
                const size_t off = (size_t)(row0 + ai * 128 + m * 16) * DM + col0;
#pragma unroll
                for (int bj = 0; bj < 2; ++bj)
#pragma unroll
                    for (int n = 0; n < 2; ++n) {
                        const f32x4 x4 = *(const f32x4*)(X + off + bj * 128 + n * 16);
                        *(f32x4*)(V + off + bj * 128 + n * 16) = x4 * ALPHA + acc[ai][bj][m][n] * coef;
                    }
                asm volatile("" ::: "memory");
            }
    }
};
struct EpiBrA {
    static constexpr bool PERM = true, AFTER_DRAIN = false;
    const bf16* Z; float* TMP;
    DI void operator()(const f32x4 (&acc)[2][2][4][2], const pg8::Unit& u, int wr, int wc, int fr, int fq) const {
        const int row0 = u.pm * 256 + wr * 64 + fr, col0 = u.pn * 256 + wc * 32 + 8 * fq;
#pragma unroll
        for (int ai = 0; ai < 2; ++ai)
#pragma unroll
            for (int m = 0; m < 4; ++m) {
                const size_t row = (size_t)(row0 + ai * 128 + m * 16);
#pragma unroll
                for (int bj = 0; bj < 2; ++bj) {
                    const int col = col0 + bj * 128;
                    const v4u g = *(const v4u*)(Z + row * ZP + GA_OFF + col);
                    const f32x4 a0 = acc[ai][bj][m][0], a1 = acc[ai][bj][m][1];
                    f32x4 t0, t1;
                    t0[0] = sigmoidf_(bflo(g.x)) * a0[0]; t0[1] = sigmoidf_(bfhi(g.x)) * a0[1]; t0[2] = sigmoidf_(bflo(g.y)) * a0[2]; t0[3] = sigmoidf_(bfhi(g.y)) * a0[3];
                    t1[0] = sigmoidf_(bflo(g.z)) * a1[0]; t1[1] = sigmoidf_(bfhi(g.z)) * a1[1]; t1[2] = sigmoidf_(bflo(g.w)) * a1[2]; t1[3] = sigmoidf_(bfhi(g.w)) * a1[3];
                    *(f32x4*)(TMP + row * DM + col) = t0; *(f32x4*)(TMP + row * DM + col + 4) = t1;
                }
                asm volatile("" ::: "memory");
            }
    }
};
struct EpiBrR {
    static constexpr bool PERM = true, AFTER_DRAIN = false;
    const bf16* Z; const float* TMP; bf16* MG;
    DI void operator()(const f32x4 (&acc)[2][2][4][2], const pg8::Unit& u, int wr, int wc, int fr, int fq) const {
        const int row0 = u.pm * 256 + wr * 64 + fr, col0 = u.pn * 256 + wc * 32 + 8 * fq;
#pragma unroll
        for (int ai = 0; ai < 2; ++ai)
#pragma unroll
            for (int m = 0; m < 4; ++m) {
                const size_t row = (size_t)(row0 + ai * 128 + m * 16);
#pragma unroll
                for (int bj = 0; bj < 2; ++bj) {
                    const int col = col0 + bj * 128;
                    const v4u g = *(const v4u*)(Z + row * ZP + GB_OFF + col);
                    const f32x4 p0 = *(const f32x4*)(TMP + row * DM + col), p1 = *(const f32x4*)(TMP + row * DM + col + 4);
                    const f32x4 a0 = acc[ai][bj][m][0], a1 = acc[ai][bj][m][1];
                    v4u w;
                    w.x = cvtpk(p0[0] + sigmoidf_(bflo(g.x)) * a0[0], p0[1] + sigmoidf_(bfhi(g.x)) * a0[1]);
                    w.y = cvtpk(p0[2] + sigmoidf_(bflo(g.y)) * a0[2], p0[3] + sigmoidf_(bfhi(g.y)) * a0[3]);
                    w.z = cvtpk(p1[0] + sigmoidf_(bflo(g.z)) * a1[0], p1[1] + sigmoidf_(bfhi(g.z)) * a1[1]);
                    w.w = cvtpk(p1[2] + sigmoidf_(bflo(g.w)) * a1[2], p1[3] + sigmoidf_(bfhi(g.w)) * a1[3]);
                    *(v4u*)(MG + row * DM + col) = w;
                }
                asm volatile("" ::: "memory");
            }
    }
};

DI void transpose_item(const float* W, int K, int N, bf16* WT, int k0, int n0, int dst_row0, float scale, LAS float* scr, int lane) {
#pragma unroll 8
    for (int i = 0; i < 32; ++i) { const int kk = 2 * i + (lane >> 5); scr[kk * 33 + (lane & 31)] = W[(size_t)(k0 + kk) * N + n0 + (lane & 31)] * scale; }
    LDS_WAIT(); asm volatile("" ::: "memory");
    const int c = lane & 7;
#pragma unroll
    for (int j = 0; j < 4; ++j) { const int n = (lane >> 3) + 8 * j; const LAS float* s = scr + (8 * c) * 33 + n;
        v4u o; o.x = cvtpk(s[0 * 33], s[1 * 33]); o.y = cvtpk(s[2 * 33], s[3 * 33]); o.z = cvtpk(s[4 * 33], s[5 * 33]); o.w = cvtpk(s[6 * 33], s[7 * 33]);
        *(v4u*)(WT + (size_t)(dst_row0 + n) * K + k0 + 8 * c) = o; }
    LDS_WAIT(); asm volatile("" ::: "memory");
}
DI int gu_row(int n0) { return n0 < DFF ? (n0 >> 7) * 256 + (n0 & 127) : ((n0 - DFF) >> 7) * 256 + 128 + ((n0 - DFF) & 127); }

struct Args { const float* in[21]; float* out; unsigned char* ws; int ph_lo, ph_hi, use_cg, pad; };
enum { I_XP = 0, I_XS, I_CK, I_CV, I_SR, I_GU1, I_DN1, I_LN1G, I_LN1B, I_WIN, I_SINK, I_GNG, I_BRA, I_BRR, I_WO, I_LN2G, I_LN2B, I_GU2, I_DN2, I_LN3G, I_LN3B };

#define KAS __attribute__((address_space(4)))
#define ARGP(kp, i) (*(const float* const KAS*)((kp) + 8 * (i)))
DI void prologue(const KAS unsigned char* kp, unsigned char* ws, LAS unsigned char* lds, int gw, int NGW, int wave, int lane) {
    LAS float* scr = (LAS float*)(lds + wave * 16384);
    constexpr int C_GU = 16 * 176, C_DN = 44 * 32, C_WIN = 16 * 184, C_BRA = 8 * 32, C_BRR = 16 * 32, C_WO = 16 * 32;
    constexpr int C_LAYER = 2 * C_GU + 2 * C_DN + C_WIN + C_BRA + C_BRR + C_WO;
    for (int it = gw; it < DEPTH * C_LAYER; it += NGW) {
        const int l = it / C_LAYER; int r = it % C_LAYER;
        unsigned char* wl = ws + WS_W + (size_t)l * WL_STRIDE;
        if (r < C_GU) { const int kb = r / 176, nb = r % 176; transpose_item(ARGP(kp, I_GU1) + (size_t)l * DM * NGU, DM, NGU, (bf16*)(wl + WO_GU1), kb * 64, nb * 32, gu_row(nb * 32), 1.f, scr, lane); continue; } r -= C_GU;
        if (r < C_DN) { const int kb = r / 32, nb = r % 32; transpose_item(ARGP(kp, I_DN1) + (size_t)l * DFF * DM, DFF, DM, (bf16*)(wl + WO_DN1), kb * 64, nb * 32, nb * 32, 1.f, scr, lane); continue; } r -= C_DN;
        if (r < C_WIN) { const int kb = r / 184, nb = r % 184; const int n0 = nb * 32; const float sc = (n0 >= KR_OFF && n0 < VR_OFF) ? 0.08838834764831845f : 1.f;
            transpose_item(ARGP(kp, I_WIN) + (size_t)l * DM * ZP, DM, ZP, (bf16*)(wl + WO_WIN), kb * 64, n0, n0, sc, scr, lane); continue; } r -= C_WIN;
        if (r < C_BRA) { const int kb = r / 32, nb = r % 32; transpose_item(ARGP(kp, I_BRA) + (size_t)l * 512 * DM, 512, DM, (bf16*)(wl + WO_BRA), kb * 64, nb * 32, nb * 32, 1.f, scr, lane); continue; } r -= C_BRA;
        if (r < C_BRR) { const int kb = r / 32, nb = r % 32; transpose_item(ARGP(kp, I_BRR) + (size_t)l * DM * DM, DM, DM, (bf16*)(wl + WO_BRR), kb * 64, nb * 32, nb * 32, 1.f, scr, lane); continue; } r -= C_BRR;
        if (r < C_WO) { const int kb = r / 32, nb = r % 32; transpose_item(ARGP(kp, I_WO) + (size_t)l * DM * DM, DM, DM, (bf16*)(wl + WO_WO), kb * 64, nb * 32, nb * 32, 1.f, scr, lane); continue; } r -= C_WO;
        if (r < C_GU) { const int kb = r / 176, nb = r % 176; transpose_item(ARGP(kp, I_GU2) + (size_t)l * DM * NGU, DM, NGU, (bf16*)(wl + WO_GU2), kb * 64, nb * 32, gu_row(nb * 32), 1.f, scr, lane); continue; } r -= C_GU;
        { const int kb = r / 32, nb = r % 32; transpose_item(ARGP(kp, I_DN2) + (size_t)l * DFF * DM, DFF, DM, (bf16*)(wl + WO_DN2), kb * 64, nb * 32, nb * 32, 1.f, scr, lane); }
    }
    float* X = (float*)(ws + WS_X); bf16* XN = (bf16*)(ws + WS_XN); bf16* OA = (bf16*)(ws + WS_OA); bf16* OR = (bf16*)(ws + WS_OR);
    for (int m = gw; m < MT; m += NGW) {
        const float* src = m < MP ? ARGP(kp, I_XP) + (size_t)m * DM : (m < MP + DBATCH ? ARGP(kp, I_XS) + (size_t)(m - MP) * DM : nullptr);
#pragma unroll
        for (int j = 0; j < 4; ++j) {
            f32x4 v = {0.f, 0.f, 0.f, 0.f};
            if (src) v = *(const f32x4*)(src + 4 * lane + 256 * j);
            *(f32x4*)(X + (size_t)m * DM + 4 * lane + 256 * j) = v;
            u32x2 w; w.x = cvtpk(v[0], v[1]); w.y = cvtpk(v[2], v[3]);
            *(u32x2*)(XN + (size_t)m * DM + 4 * lane + 256 * j) = w;
            if (m >= MP + DBATCH) { const u32x2 z = {0u, 0u}; *(u32x2*)(OR + (size_t)m * DM + 4 * lane + 256 * j) = z; if (j < 2) *(u32x2*)(OA + (size_t)m * 512 + 4 * lane + 256 * j) = z; }
        }
    }
}

DI void ln_phase(const float* V, const float* g, const float* b, float* X, bf16* XN, float* yp, float* ys, int gw, int NGW, int lane) {
    f32x4 gg[4], bb[4];
#pragma unroll
    for (int j = 0; j < 4; ++j) { gg[j] = *(const f32x4*)(g + 4 * lane + 256 * j); bb[j] = *(const f32x4*)(b + 4 * lane + 256 * j); }
    for (int m = gw; m < MT; m += NGW) {
        f32x4 v[4]; float s = 0.f;
#pragma unroll
        for (int j = 0; j < 4; ++j) { v[j] = *(const f32x4*)(V + (size_t)m * DM + 4 * lane + 256 * j); s += (v[j][0] + v[j][1]) + (v[j][2] + v[j][3]); }
        const float mean = wave_sum(s) * (1.f / DM); float s2 = 0.f;
#pragma unroll
        for (int j = 0; j < 4; ++j) { v[j] = v[j] - mean; s2 += (v[j][0] * v[j][0] + v[j][1] * v[j][1]) + (v[j][2] * v[j][2] + v[j][3] * v[j][3]); }
        const float rstd = 1.f / sqrtf(wave_sum(s2) * (1.f / DM) + LN_EPS);
        float* yo = nullptr;
        if (yp) { if (m < MP) yo = yp + (size_t)m * DM; else if (m < MP + DBATCH) yo = ys + (size_t)(m - MP) * DM; }
#pragma unroll
        for (int j = 0; j < 4; ++j) {
            const f32x4 o = v[j] * rstd * gg[j] + bb[j];
            *(f32x4*)(X + (size_t)m * DM + 4 * lane + 256 * j) = o;
            u32x2 w; w.x = cvtpk(o[0], o[1]); w.y = cvtpk(o[2], o[3]);
            *(u32x2*)(XN + (size_t)m * DM + 4 * lane + 256 * j) = w;
            if (yo) *(f32x4*)(yo + 4 * lane + 256 * j) = o;
        }
    }
}
DI void attn_prompt_unit(LAS unsigned char* lds, int unit, const bf16* Z, bf16* OA, const float* sinks, float* out_wk, float* out_wv, int tid, int wave, int lane) {
    const int b = unit >> 7, kvh = (unit >> 6) & 1, qb = unit & 63;
    LAS bf16* Ks = (LAS bf16*)lds; LAS bf16* VT = Ks + 256 * 72;
    for (int c = tid; c < 2048; c += 512) {
        const int j = c >> 3, ch = c & 7;
        v4u kv = {0u, 0u, 0u, 0u}, vv = {0u, 0u, 0u, 0u};
        if (qb > 0 || j >= 128) { const size_t row = (size_t)b * SEQ + (size_t)(qb - 1) * 128 + j;
            kv = *(const v4u*)(Z + row * ZP + KA_OFF + kvh * 64 + ch * 8); vv = *(const v4u*)(Z + row * ZP + VA_OFF + kvh * 64 + ch * 8); }
        *(LAS v4u*)(Ks + j * 72 + ch * 8) = kv;
        const unsigned vw[4] = {vv.x, vv.y, vv.z, vv.w};
#pragma unroll
        for (int i = 0; i < 4; ++i) { VT[(ch * 8 + 2 * i) * 264 + j] = (bf16)(vw[i] & 0xffffu); VT[(ch * 8 + 2 * i + 1) * 264 + j] = (bf16)(vw[i] >> 16); }
        if (qb == 63 && j >= 128) {
            const size_t o = ((size_t)(b * 128 + (j - 128)) * 2 + kvh) * 64 + ch * 8;
            const unsigned kw[4] = {kv.x, kv.y, kv.z, kv.w};
            f32x4 k0 = {bflo(kw[0]), bfhi(kw[0]), bflo(kw[1]), bfhi(kw[1])}, k1 = {bflo(kw[2]), bfhi(kw[2]), bflo(kw[3]), bfhi(kw[3])};
            f32x4 v0 = {bflo(vw[0]), bfhi(vw[0]), bflo(vw[1]), bfhi(vw[1])}, v1 = {bflo(vw[2]), bfhi(vw[2]), bflo(vw[3]), bfhi(vw[3])};
            *(f32x4*)(out_wk + o) = k0; *(f32x4*)(out_wk + o + 4) = k1; *(f32x4*)(out_wv + o) = v0; *(f32x4*)(out_wv + o + 4) = v1;
        }
    }
    __syncthreads();
    const int fr = lane & 15, g = lane >> 4;
    const int hq = kvh * 4 + (wave >> 1);
    const float slope = fexp2(-(float)(hq + 1)), sink = sinks[hq];
#pragma unroll 1
    for (int st = 0; st < 4; ++st) {
        const int i0 = (wave & 1) * 64 + st * 16, i = i0 + fr, T0 = i0 >> 4;
        const size_t qrow = (size_t)b * SEQ + (size_t)qb * 128 + i;
        bf16x8 qf[2];
#pragma unroll
        for (int ks = 0; ks < 2; ++ks) qf[ks] = *(const bf16x8*)(Z + qrow * ZP + QA_OFF + hq * 64 + ks * 32 + 8 * g);
        f32x4 s[10];
#pragma unroll
        for (int kt = 0; kt < 10; ++kt) {
            const int T = (T0 + kt) < 15 ? (T0 + kt) : 15; const int key = 16 * T + fr;
            const bf16x8 a0 = *(const LAS bf16x8*)(Ks + key * 72 + 8 * g), a1 = *(const LAS bf16x8*)(Ks + key * 72 + 32 + 8 * g);
            f32x4 z4 = {0.f, 0.f, 0.f, 0.f};
            z4 = MFMA16(a0, qf[0], z4); s[kt] = MFMA16(a1, qf[1], z4);
        }
        float mx = sink;
#pragma unroll
        for (int kt = 0; kt < 10; ++kt)
#pragma unroll
            for (int r = 0; r < 4; ++r) {
                const int j = 16 * (T0 + kt) + 4 * g + r, dist = i + 128 - j;
                const bool valid = (dist >= 0) && (dist <= 128) && (qb > 0 || j >= 128);
                const float v = valid ? s[kt][r] * 0.125f - slope * (float)dist : -1e30f;
                s[kt][r] = v; mx = fmaxf(mx, v);
            }
        mx = fmaxf(mx, __shfl_xor(mx, 16)); mx = fmaxf(mx, __shfl_xor(mx, 32));
        float sum = 0.f;
#pragma unroll
        for (int kt = 0; kt < 10; ++kt)
#pragma unroll
            for (int r = 0; r < 4; ++r) { const float p = fexp(s[kt][r] - mx); s[kt][r] = p; sum += p; }
        sum += __shfl_xor(sum, 16); sum += __shfl_xor(sum, 32);
        sum += fexp(sink - mx);
        const float inv = 1.f / sum;
        f32x4 o[4];
#pragma unroll
        for (int dt = 0; dt < 4; ++dt) o[dt] = (f32x4){0.f, 0.f, 0.f, 0.f};
#pragma unroll
        for (int p = 0; p < 5; ++p) {
            v4u pw; pw.x = cvtpk(s[2 * p][0], s[2 * p][1]); pw.y = cvtpk(s[2 * p][2], s[2 * p][3]); pw.z = cvtpk(s[2 * p + 1][0], s[2 * p + 1][1]); pw.w = cvtpk(s[2 * p + 1][2], s[2 * p + 1][3]);
            const bf16x8 pb = __builtin_bit_cast(bf16x8, pw);
            const int Ta = (T0 + 2 * p) < 15 ? (T0 + 2 * p) : 15, Tb = (T0 + 2 * p + 1) < 15 ? (T0 + 2 * p + 1) : 15;
#pragma unroll
            for (int dt = 0; dt < 4; ++dt) {
                const int d = 16 * dt + fr;
                const u32x2 lo = *(const LAS u32x2*)(VT + d * 264 + 16 * Ta + 4 * g), hi = *(const LAS u32x2*)(VT + d * 264 + 16 * Tb + 4 * g);
                o[dt] = MFMA16(mk8(lo, hi), pb, o[dt]);
            }
        }
#pragma unroll
        for (int dt = 0; dt < 4; ++dt) {
            u32x2 w; w.x = cvtpk(o[dt][0] * inv, o[dt][1] * inv); w.y = cvtpk(o[dt][2] * inv, o[dt][3] * inv);
            *(u32x2*)(OA + qrow * 512 + hq * 64 + 16 * dt + 4 * g) = w;
        }
    }
    __syncthreads();
}

DI void attn_sample_unit(LAS unsigned char* lds, int unit, int l, const bf16* Z, bf16* OA, const float* sinks, const float* cache_k, const float* cache_v, float* out_k, float* out_v, int tid, int wave, int lane) {
    const int db = unit >> 1, kvh = unit & 1;
    LAS float* Kc = (LAS float*)lds;
    LAS float* Vc = Kc + 129 * 65 + 3;
    LAS float* qv = Vc + 129 * 64;
    LAS float* sc = qv + 256;
    const size_t cbase = ((size_t)(l * DBATCH + db) * 128) * 128 + kvh * 64;
    for (int idx = tid; idx < 2048; idx += 512) {
        const int j = idx >> 4, c4 = idx & 15;
        const f32x4 k4 = *(const f32x4*)(cache_k + cbase + (size_t)j * 128 + c4 * 4), v4 = *(const f32x4*)(cache_v + cbase + (size_t)j * 128 + c4 * 4);
#pragma unroll
        for (int i = 0; i < 4; ++i) { Kc[j * 65 + c4 * 4 + i] = k4[i]; Vc[j * 64 + c4 * 4 + i] = v4[i]; }
        if (j >= 1) { *(f32x4*)(out_k + cbase + (size_t)(j - 1) * 128 + c4 * 4) = k4; *(f32x4*)(out_v + cbase + (size_t)(j - 1) * 128 + c4 * 4) = v4; }
    }
    const size_t zrow = (size_t)(MP + db) * ZP;
    if (tid < 64) {
        const float kn = bf2f(Z[zrow + KA_OFF + kvh * 64 + tid]), vn = bf2f(Z[zrow + VA_OFF + kvh * 64 + tid]);
        Kc[128 * 65 + tid] = kn; Vc[128 * 64 + tid] = vn;
        out_k[cbase + (size_t)127 * 128 + tid] = kn; out_v[cbase + (size_t)127 * 128 + tid] = vn;
    }
    if (tid >= 256) { const int t = tid - 256; qv[t] = bf2f(Z[zrow + QA_OFF + kvh * 256 + t]); }
    __syncthreads();
    for (int idx = tid; idx < 516; idx += 512) {
        const int h = idx / 129, j = idx - h * 129;
        float dot = 0.f;
#pragma unroll 8
        for (int d = 0; d < 64; ++d) dot += qv[h * 64 + d] * Kc[j * 65 + d];
        const float slope = fexp2(-(float)(kvh * 4 + h + 1));
        sc[h * 132 + j] = dot * 0.125f - slope * (float)(128 - j);
    }
    __syncthreads();
    if (wave < 4) {
        const int h = wave; const float sink = sinks[kvh * 4 + h];
        const float s0 = sc[h * 132 + lane], s1 = sc[h * 132 + 64 + lane], s2 = lane == 0 ? sc[h * 132 + 128] : -1e30f;
        const float mx = fmaxf(wave_max(fmaxf(fmaxf(s0, s1), s2)), sink);
        const float p0 = fexp(s0 - mx), p1 = fexp(s1 - mx), p2 = lane == 0 ? fexp(s2 - mx) : 0.f;
        const float inv = 1.f / (wave_sum(p0 + p1 + p2) + fexp(sink - mx));
        sc[h * 132 + lane] = p0 * inv; sc[h * 132 + 64 + lane] = p1 * inv; if (lane == 0) sc[h * 132 + 128] = p2 * inv;
    }
    __syncthreads();
    if (tid < 256) {
        const int h = tid >> 6, d = tid & 63; float o = 0.f;
#pragma unroll 8
        for (int j = 0; j < 129; ++j) o += sc[h * 132 + j] * Vc[j * 64 + d];
        OA[(size_t)(MP + db) * 512 + (kvh * 4 + h) * 64 + d] = (bf16)(cvtpk(o, 0.f) & 0xffffu);
    }
    __syncthreads();
}

DI void stage_vt(LAS bf16* VT, const bf16* Z, size_t rowbase, int h, int tid) {
    for (int idx = tid; idx < 128 * 32; idx += 512) {
        const int j = idx >> 5, ch = idx & 31;
        const v4u vv = *(const v4u*)(Z + (rowbase + j) * ZP + VR_OFF + h * 256 + ch * 8);
        const unsigned vw[4] = {vv.x, vv.y, vv.z, vv.w};
#pragma unroll
        for (int i = 0; i < 4; ++i) { VT[(ch * 8 + 2 * i) * 136 + j] = (bf16)(vw[i] & 0xffffu); VT[(ch * 8 + 2 * i + 1) * 136 + j] = (bf16)(vw[i] >> 16); }
    }
}
DI float ret_log2_gamma(int h) { return log2f(1.f - exp2f(-5.f - (float)h)); }

DI void ret_u_unit(LAS unsigned char* lds, int unit, const bf16* Z, float* U, int tid, int wave, int lane) {
    const int c = unit & 63, h = (unit >> 6) & 3, b = unit >> 8;
    const size_t rowbase = (size_t)b * SEQ + (size_t)c * 128;
    LAS bf16* VT = (LAS bf16*)lds; LAS bf16* KT = VT + 256 * 136;
    const float l2g = ret_log2_gamma(h);
    stage_vt(VT, Z, rowbase, h, tid);
    for (int idx = tid; idx < 128 * 16; idx += 512) {
        const int j = idx >> 4, ch = idx & 15;
        const v4u kv = *(const v4u*)(Z + (rowbase + j) * ZP + KR_OFF + h * 128 + ch * 8);
        const float sc = fexp2((float)(127 - j) * l2g);
        const unsigned kw[4] = {kv.x, kv.y, kv.z, kv.w};
#pragma unroll
        for (int i = 0; i < 4; ++i) { const unsigned pk = cvtpk(bflo(kw[i]) * sc, bfhi(kw[i]) * sc);
            KT[(ch * 8 + 2 * i) * 136 + j] = (bf16)(pk & 0xffffu); KT[(ch * 8 + 2 * i + 1) * 136 + j] = (bf16)(pk >> 16); }
    }
    __syncthreads();
    const int fr = lane & 15, g = lane >> 4;
    f32x4 acc[2][8];
#pragma unroll
    for (int t = 0; t < 2; ++t)
#pragma unroll
        for (int dt = 0; dt < 8; ++dt) acc[t][dt] = (f32x4){0.f, 0.f, 0.f, 0.f};
#pragma unroll
    for (int ks = 0; ks < 4; ++ks) {
        bf16x8 a[2];
#pragma unroll
        for (int t = 0; t < 2; ++t) a[t] = *(const LAS bf16x8*)(VT + (16 * (2 * wave + t) + fr) * 136 + ks * 32 + 8 * g);
#pragma unroll
        for (int dt = 0; dt < 8; ++dt) {
            const bf16x8 bq = *(const LAS bf16x8*)(KT + (16 * dt + fr) * 136 + ks * 32 + 8 * g);
#pragma unroll
            for (int t = 0; t < 2; ++t) acc[t][dt] = MFMA16(a[t], bq, acc[t][dt]);
        }
    }
    float* Uu = U + (size_t)unit * 32768;
#pragma unroll
    for (int t = 0; t < 2; ++t)
#pragma unroll
        for (int dt = 0; dt < 8; ++dt)
#pragma unroll
            for (int r = 0; r < 4; ++r) Uu[(16 * (2 * wave + t) + 4 * g + r) * 128 + 16 * dt + fr] = acc[t][dt][r];
    __syncthreads();
}

DI void ret_scan(const float* U, bf16* SC, float* out_rp  , int gtid, int gthreads) {
    for (int pi = gtid; pi < 131072; pi += gthreads) {
        const int bh = pi >> 14, rem = pi & 16383, e = rem >> 6, d2 = (rem & 63) * 2, h = bh & 3;
        const float dec = fexp2(128.f * ret_log2_gamma(h));
        float s0 = 0.f, s1 = 0.f;
        const size_t eo = (size_t)e * 128 + d2;
#pragma unroll 8
        for (int c = 0; c < 64; ++c) {
            const size_t uo = (size_t)(bh * 64 + c) * 32768 + eo;
            const f32x2_t u2 = *(const f32x2_t*)(U + uo);
            *(unsigned*)(SC + uo) = cvtpk(s0, s1);
            s0 = dec * s0 + u2[0]; s1 = dec * s1 + u2[1];
        }
        out_rp[((size_t)bh * 128 + d2) * 256 + e] = s0; out_rp[((size_t)bh * 128 + d2 + 1) * 256 + e] = s1;
    }
}

DI void ret_out_unit(LAS unsigned char* lds, int unit, const bf16* Z, const bf16* SC, const float* gn_g, bf16* OR, int tid, int wave, int lane) {
    const int c = unit & 63, h = (unit >> 6) & 3, b = unit >> 8;
    const size_t rowbase = (size_t)b * SEQ + (size_t)c * 128;
    LAS bf16* VT = (LAS bf16*)lds;
    const float l2g = ret_log2_gamma(h);
    stage_vt(VT, Z, rowbase, h, tid);
    __syncthreads();
    const int fr = lane & 15, g = lane >> 4, w = wave;
    const int i = 16 * w + fr; const size_t rowi = rowbase + i;
    bf16x8 qf[4], qs[4];
    { const float qsc = fexp2((float)(i + 1) * l2g);
#pragma unroll
      for (int ks = 0; ks < 4; ++ks) { const v4u qv = *(const v4u*)(Z + rowi * ZP + QR_OFF + h * 128 + ks * 32 + 8 * g);
          qf[ks] = __builtin_bit_cast(bf16x8, qv);
          v4u t; t.x = cvtpk(bflo(qv.x) * qsc, bfhi(qv.x) * qsc); t.y = cvtpk(bflo(qv.y) * qsc, bfhi(qv.y) * qsc); t.z = cvtpk(bflo(qv.z) * qsc, bfhi(qv.z) * qsc); t.w = cvtpk(bflo(qv.w) * qsc, bfhi(qv.w) * qsc);
          qs[ks] = __builtin_bit_cast(bf16x8, t); } }
    f32x4 sT[8];
#pragma unroll
    for (int jt = 0; jt < 8; ++jt) {
        sT[jt] = (f32x4){0.f, 0.f, 0.f, 0.f};
        if (jt <= w) {
#pragma unroll
            for (int ks = 0; ks < 4; ++ks) { const bf16x8 a = *(const bf16x8*)(Z + (rowbase + 16 * jt + fr) * ZP + KR_OFF + h * 128 + ks * 32 + 8 * g); sT[jt] = MFMA16(a, qf[ks], sT[jt]); }
#pragma unroll
            for (int r = 0; r < 4; ++r) { const int dd = i - (16 * jt + 4 * g + r); sT[jt][r] = dd >= 0 ? sT[jt][r] * fexp2((float)dd * l2g) : 0.f; }
        }
    }
    f32x4 o[16];
#pragma unroll
    for (int et = 0; et < 16; ++et) o[et] = (f32x4){0.f, 0.f, 0.f, 0.f};
#pragma unroll
    for (int p = 0; p < 4; ++p) {
        if (2 * p <= w) {
            v4u pw; pw.x = cvtpk(sT[2 * p][0], sT[2 * p][1]); pw.y = cvtpk(sT[2 * p][2], sT[2 * p][3]); pw.z = cvtpk(sT[2 * p + 1][0], sT[2 * p + 1][1]); pw.w = cvtpk(sT[2 * p + 1][2], sT[2 * p + 1][3]);
            const bf16x8 pb = __builtin_bit_cast(bf16x8, pw);
#pragma unroll
            for (int et = 0; et < 16; ++et) {
                const int e = 16 * et + fr;
                const u32x2 lo = *(const LAS u32x2*)(VT + e * 136 + 32 * p + 4 * g), hi = *(const LAS u32x2*)(VT + e * 136 + 32 * p + 16 + 4 * g);
                o[et] = MFMA16(mk8(lo, hi), pb, o[et]);
            }
        }
    }
    const bf16* Su = SC + (size_t)unit * 32768;
#pragma unroll
    for (int ks = 0; ks < 4; ++ks)
#pragma unroll
        for (int et = 0; et < 16; ++et) { const bf16x8 a = *(const bf16x8*)(Su + (16 * et + fr) * 128 + ks * 32 + 8 * g); o[et] = MFMA16(a, qs[ks], o[et]); }
    float s = 0.f;
#pragma unroll
    for (int et = 0; et < 16; ++et) s += (o[et][0] + o[et][1]) + (o[et][2] + o[et][3]);
    s += __shfl_xor(s, 16); s += __shfl_xor(s, 32);
    const float mean = s * (1.f / 256.f); float q = 0.f;
#pragma unroll
    for (int et = 0; et < 16; ++et) { o[et] = o[et] - mean; q += (o[et][0] * o[et][0] + o[et][1] * o[et][1]) + (o[et][2] * o[et][2] + o[et][3] * o[et][3]); }
    q += __shfl_xor(q, 16); q += __shfl_xor(q, 32);
    const float rstd = 1.f / sqrtf(q * (1.f / 256.f) + GN_EPS);
#pragma unroll
    for (int et = 0; et < 16; ++et) {
        const int e0 = 16 * et + 4 * g;
        const f32x4 gn = *(const f32x4*)(gn_g + h * 256 + e0);
        const u32x2 gr = *(const u32x2*)(Z + rowi * ZP + GR_OFF + h * 256 + e0);
        u32x2 wv; wv.x = cvtpk(o[et][0] * rstd * gn[0] * siluf_(bflo(gr.x)), o[et][1] * rstd * gn[1] * siluf_(bfhi(gr.x)));
        wv.y = cvtpk(o[et][2] * rstd * gn[2] * siluf_(bflo(gr.y)), o[et][3] * rstd * gn[3] * siluf_(bfhi(gr.y)));
        *(u32x2*)(OR + rowi * DM + h * 256 + e0) = wv;
    }
    __syncthreads();
}

DI void ret_sample_unit(LAS unsigned char* lds, int unit, const bf16* Z, const float* S0  , float* Sout  , const float* gn_g, bf16* OR, int tid, int wave, int lane) {
    const int db = unit >> 2, h = unit & 3;
    LAS float* qs = (LAS float*)lds; LAS float* ks = qs + 128; LAS float* vs = ks + 128; LAS float* part = vs + 256; LAS float* red = part + 8 * 256;
    const size_t zrow = (size_t)(MP + db) * ZP;
    if (tid < 128) qs[tid] = bf2f(Z[zrow + QR_OFF + h * 128 + tid]);
    else if (tid < 256) ks[tid - 128] = bf2f(Z[zrow + KR_OFF + h * 128 + (tid - 128)]);
    else vs[tid - 256] = bf2f(Z[zrow + VR_OFF + h * 256 + (tid - 256)]);
    __syncthreads();
    const float gam = 1.f - exp2f(-5.f - (float)h);
    const float qk = wave_sum(qs[lane] * ks[lane] + qs[lane + 64] * ks[lane + 64]);
    const int eq = lane, dg = wave;
    const f32x4 v4 = *(const LAS f32x4*)(vs + 4 * eq);
    f32x4 po = {0.f, 0.f, 0.f, 0.f};
    const size_t sbase = ((size_t)(db * 4 + h) * 128) * 256;
#pragma unroll 4
    for (int dd = 0; dd < 16; ++dd) {
        const int d = 16 * dg + dd;
        const f32x4 s4 = *(const f32x4*)(S0 + sbase + (size_t)d * 256 + 4 * eq);
        const float qd = qs[d], kd = ks[d];
        po = po + s4 * qd;
        *(f32x4*)(Sout + sbase + (size_t)d * 256 + 4 * eq) = s4 * gam + v4 * kd;
    }
    *(LAS f32x4*)(part + dg * 256 + 4 * eq) = po;
    __syncthreads();
    float o = 0.f;
    if (tid < 256) { float a = 0.f;
#pragma unroll
        for (int k = 0; k < 8; ++k) a += part[k * 256 + tid];
        o = qk * vs[tid] + gam * a; }
    const float ws1 = wave_sum(tid < 256 ? o : 0.f);
    if (lane == 0) red[wave] = ws1;
    __syncthreads();
    const float mean = (red[0] + red[1] + red[2] + red[3]) * (1.f / 256.f);
    const float dv = tid < 256 ? o - mean : 0.f;
    const float ws2 = wave_sum(dv * dv);
    if (lane == 0) red[8 + wave] = ws2;
    __syncthreads();
    const float rstd = 1.f / sqrtf((red[8] + red[9] + red[10] + red[11]) * (1.f / 256.f) + GN_EPS);
    if (tid < 256) {
        const float gr = bf2f(Z[zrow + GR_OFF + h * 256 + tid]);
        const float y = dv * rstd * gn_g[h * 256 + tid] * siluf_(gr);
        OR[(size_t)(MP + db) * DM + h * 256 + tid] = (bf16)(cvtpk(y, 0.f) & 0xffffu);
    }
    __syncthreads();
}
__global__ void __launch_bounds__(512, 2) mk_fwd(Args args) {
    extern __shared__ __attribute__((aligned(16))) unsigned char lds_raw[];
    LAS unsigned char* lds = (LAS unsigned char*)lds_raw;
    volatile LAS unsigned* MISC = (volatile LAS unsigned*)(lds + MISC_OFF);
    const int tid0 = threadIdx.x;
    const int G = gridDim.x, bx = blockIdx.x;
    const int NGW = G * 8;
    const KAS unsigned char* kp0 = (const KAS unsigned char*)__builtin_amdgcn_kernarg_segment_ptr();
    unsigned char* ws = args.ws;
    for (int u = tid0; u < (LDS_BYTES - MISC_OFF) / 4; u += 512) ((LAS unsigned*)(lds + MISC_OFF))[u] = 0u;
    __syncthreads();
    XcdBarrier bar; bar.bar = (unsigned*)(ws + WS_CTL) + CW_BAR; bar.x = 0; bar.st = nullptr;
    if (MK_SINGLE && !args.use_cg) bar = xcd_barrier_post((unsigned*)(ws + WS_CTL) + CW_BAR, MISC + 8);

    const int ph_hi = args.ph_hi, use_cg = args.use_cg;
    for (int ph = args.ph_lo; ph < ph_hi; ++ph) {
        const KAS unsigned char* kp = kp0; asm volatile("" : "+s"(kp));
        int tid = tid0; asm volatile("" : "+v"(tid));
        const int lane = tid & 63, wave = __builtin_amdgcn_readfirstlane(tid >> 6), gw = bx * 8 + wave;
        ws = *(unsigned char* const KAS*)(kp + 8 * 22);
        float* out = *(float* const KAS*)(kp + 8 * 21);
        float* X = (float*)(ws + WS_X); float* V = (float*)(ws + WS_V); bf16* XN = (bf16*)(ws + WS_XN); bf16* Z = (bf16*)(ws + WS_Z); bf16* H = (bf16*)(ws + WS_H);
        bf16* OA = (bf16*)(ws + WS_OA); bf16* OR = (bf16*)(ws + WS_OR); bf16* MG = (bf16*)(ws + WS_MG); float* TMP = (float*)(ws + WS_TMP);
        float* U = (float*)(ws + WS_U); bf16* SC = (bf16*)(ws + WS_SC);
        if (ph == 0) {
            prologue(kp, ws, lds, gw, NGW, wave, lane);
        } else {
            const int l = (ph - 1) / NPH_LAYER, sp = (ph - 1) % NPH_LAYER;
            unsigned char* wl = ws + WS_W + (size_t)l * WL_STRIDE;
            switch (sp) {
            case 0: case 10: {
#ifndef SKIP_UP
                pg8::Gemm g{XN, (const bf16*)(wl + (sp == 0 ? WO_GU1 : WO_GU2)), MT, NGU, DM}; pg8::StaticOrder S; S.init(MT, NGU, G, bx);
                EpiSwiglu E{H};
                pg8::gemm_phase<EpiSwiglu, pg8::StaticOrder, true, true>(lds, g, S, E);
#endif
            } break;
            case 1: case 11: {
#ifndef SKIP_DN
                pg8::Gemm g{H, (const bf16*)(wl + (sp == 1 ? WO_DN1 : WO_DN2)), MT, DM, DFF}; pg8::StaticOrder S; S.init(MT, DM, G, bx);
                EpiRes E{X, V, 0.5f};
                pg8::gemm_phase<EpiRes, pg8::StaticOrder, true, true>(lds, g, S, E);
#endif
            } break;
            case 2: case 9: case 12: {
                const float* gp = ARGP(kp, sp == 2 ? I_LN1G : (sp == 9 ? I_LN2G : I_LN3G)) + l * DM;
                const float* bp = ARGP(kp, sp == 2 ? I_LN1B : (sp == 9 ? I_LN2B : I_LN3B)) + l * DM;
                const bool last = (sp == 12 && l == DEPTH - 1);
                ln_phase(V, gp, bp, X, XN, last ? out + O_YP : nullptr, last ? out + O_YS : nullptr, gw, NGW, lane);
            } break;
            case 3: {
#ifndef SKIP_WIN
                pg8::Gemm g{XN, (const bf16*)(wl + WO_WIN), MT, ZP, DM}; pg8::StaticOrder S; S.init(MT, ZP, G, bx);
                pg8::EpiBf16<0> E{Z, ZP, nullptr, 0, 0, 1.f};
                pg8::gemm_phase<pg8::EpiBf16<0>, pg8::StaticOrder, true, true>(lds, g, S, E);
#endif
            } break;
            case 4: {
                const float* sinks = ARGP(kp, I_SINK) + l * 8; const float* gng = ARGP(kp, I_GNG) + l * DM;
#ifndef SKIP_MIX
                for (int it = bx; it < 1536; it += G) {
                    int tid = tid0; asm volatile("" : "+v"(tid)); const int lane = tid & 63;
                    if (it < 256) {
#ifndef SKIP_ATTN
 attn_prompt_unit(lds, it, Z, OA, sinks, out + O_WKP + (size_t)l * 32768, out + O_WVP + (size_t)l * 32768, tid, wave, lane);
#endif
 }
                    else if (it < 768) {
#ifndef SKIP_RETU
 ret_u_unit(lds, it - 256, Z, U, tid, wave, lane);
#endif
 }
                    else if (it < 1024) {
#ifndef SKIP_SATTN
 attn_sample_unit(lds, it - 768, l, Z, OA, sinks, ARGP(kp, I_CK), ARGP(kp, I_CV), out + O_WKS, out + O_WVS, tid, wave, lane);
#endif
 }
                    else {
#ifndef SKIP_SRET
 ret_sample_unit(lds, it - 1024, Z, ARGP(kp, I_SR) + (size_t)l * 16777216, out + O_RS + (size_t)l * 16777216, gng, OR, tid, wave, lane);
#endif
 }
                }
#endif
            } break;
            case 5: {
                ret_scan(U, SC, out + O_RP + (size_t)l * 262144, bx * 512 + tid, G * 512);
            } break;
            case 6: {
                const float* gng = ARGP(kp, I_GNG) + l * DM;
#ifndef SKIP_RETC
                for (int it = bx; it < 512; it += G) { int tid = tid0; asm volatile("" : "+v"(tid)); const int lane = tid & 63; ret_out_unit(lds, it, Z, SC, gng, OR, tid, wave, lane); }
#endif
            } break;
            case 7: {
#ifndef SKIP_BR
                { pg8::Gemm g{OA, (const bf16*)(wl + WO_BRA), MT, DM, 512}; pg8::StaticOrder S; S.init(MT, DM, G, bx);
                  EpiBrA E{Z, TMP};
                  pg8::gemm_phase<EpiBrA, pg8::StaticOrder, true, true>(lds, g, S, E); }
                { pg8::Gemm g{OR, (const bf16*)(wl + WO_BRR), MT, DM, DM}; pg8::StaticOrder S; S.init(MT, DM, G, bx);
                  EpiBrR E{Z, TMP, MG};
                  pg8::gemm_phase<EpiBrR, pg8::StaticOrder, true, true>(lds, g, S, E); }
#endif
            } break;
            case 8: {
#ifndef SKIP_WO
                pg8::Gemm g{MG, (const bf16*)(wl + WO_WO), MT, DM, DM}; pg8::StaticOrder S; S.init(MT, DM, G, bx);
                EpiRes E{X, V, 1.0f};
                pg8::gemm_phase<EpiRes, pg8::StaticOrder, true, true>(lds, g, S, E);
#endif
            } break;
            default: break;
            }
        }
        if (ph + 1 < ph_hi) {
            if (use_cg) cg::this_grid().sync(); else xcd_barrier(bar);
        }
    }
}

extern "C" void kernel_launch(void* const* d_in, const int* in_sizes, int n_in, void* d_out, int out_size, void* d_ws, size_t ws_size, hipStream_t stream) {
    static int grid = 0;
    if (grid == 0) {
        if (n_in != 21 || (size_t)out_size != O_TOTAL || ws_size < WS_END) { fprintf(stderr, "kernel_launch: unexpected sizes n_in %d out %d ws %zu\n", n_in, out_size, ws_size); grid = -1; return; }
        int dev = 0, cus = 0, per_cu = 0;
        if (hipGetDevice(&dev) != hipSuccess || hipDeviceGetAttribute(&cus, hipDeviceAttributeMultiprocessorCount, dev) != hipSuccess) { grid = -1; return; }
        if (hipFuncSetAttribute((const void*)mk_fwd, hipFuncAttributeMaxDynamicSharedMemorySize, LDS_BYTES) != hipSuccess) { fprintf(stderr, "kernel_launch: hipFuncSetAttribute failed\n"); grid = -1; return; }
        if (hipOccupancyMaxActiveBlocksPerMultiprocessor(&per_cu, (const void*)mk_fwd, 512, LDS_BYTES) != hipSuccess || per_cu < 1) { fprintf(stderr, "kernel_launch: occupancy query says %d\n", per_cu); per_cu = 1; }
        (void)hipGetLastError();
        grid = cus;
    }
    if (grid < 0) return;
    if (hipMemsetAsync((char*)d_ws + WS_CTL, 0, CTL_BYTES, stream) != hipSuccess) { fprintf(stderr, "kernel_launch: memset failed\n"); return; }
    Args a{};
    for (int i = 0; i < 21; ++i) a.in[i] = (const float*)d_in[i];
    a.out = (float*)d_out; a.ws = (unsigned char*)d_ws; a.use_cg = MK_USE_CG; a.pad = 0;
#if MK_SINGLE
    a.ph_lo = 0; a.ph_hi = NPHASES;
    void* kargs[] = {&a};
    hipError_t e = hipLaunchCooperativeKernel((const void*)mk_fwd, dim3(grid), dim3(512), kargs, LDS_BYTES, stream);
    if (e != hipSuccess) fprintf(stderr, "kernel_launch: cooperative launch failed: %s (grid %d)\n", hipGetErrorString(e), grid);
#else
    for (int ph = 0; ph < NPHASES; ++ph) {
        a.ph_lo = ph; a.ph_hi = ph + 1;
        hipLaunchKernelGGL(mk_fwd, dim3(grid), dim3(512), LDS_BYTES, stream, a);
    }
#endif
}
```
